# Optimizing an MI355X kernel written in HIP

```python
import jax, jax.numpy as jnp
from jax import lax
import numpy as np

D_MODEL = 1024
BATCH = 2
SEQ = 8192
DEPTH = 1

MIX_WIDTH = D_MODEL
HEAD_DIM = 64
ATTN_WIDTH = MIX_WIDTH // 2
N_Q_HEADS = ATTN_WIDTH // HEAD_DIM
N_KV_HEADS = 2
KV_WIDTH = N_KV_HEADS * HEAD_DIM
TOK_WIDTH = MIX_WIDTH - ATTN_WIDTH
N_TOK_HEADS = TOK_WIDTH // HEAD_DIM
N_IN = ATTN_WIDTH + 2 * KV_WIDTH + 2 * TOK_WIDTH
CHUNK = 128
Q_BLOCK = 128
GRID_W = 64
ROPE_THETA = 10000.0
D_FF = 2816
CONV_W = 3
N_MOD = 6
EPS = 1e-6

kernel_name = "hybrid_attn_gmlp_convffn_encoder_layer"


def rmsnorm(x, g):
    xf = x.astype(jnp.float32)
    y = xf * lax.rsqrt(jnp.mean(xf * xf, axis=-1, keepdims=True) + EPS)
    return (y * g.astype(jnp.float32)).astype(x.dtype)


def axial_rope_tables(seq_len):
    rows = seq_len // GRID_W
    row_id = jnp.broadcast_to(jnp.arange(rows)[:, None], (rows, GRID_W)).reshape(-1).astype(jnp.float32)
    col_id = jnp.broadcast_to(jnp.arange(GRID_W)[None, :], (rows, GRID_W)).reshape(-1).astype(jnp.float32)
    axis_dim = HEAD_DIM // 2
    inv_freq = jnp.power(jnp.float32(ROPE_THETA), -jnp.arange(0, axis_dim, 2, dtype=jnp.float32) / axis_dim)
    ang_r = row_id[:, None] * inv_freq[None, :]
    ang_c = col_id[:, None] * inv_freq[None, :]
    ang = jnp.concatenate([ang_r, ang_r, ang_c, ang_c], axis=-1)
    return jnp.cos(ang), jnp.sin(ang)


def rotate_half(a):
    a1, a2 = jnp.split(a, 2, axis=-1)
    return jnp.concatenate([-a2, a1], axis=-1)


def apply_axial_rope(x, cos, sin):
    xr, xc = jnp.split(x, 2, axis=-1)
    rot = jnp.concatenate([rotate_half(xr), rotate_half(xc)], axis=-1)
    return x * cos + rot * sin


def block_attention(q, k, v):
    B, S = q.shape[0], q.shape[1]
    groups = N_Q_HEADS // N_KV_HEADS
    nb = S // Q_BLOCK
    qb = q.reshape(B, nb, Q_BLOCK, N_KV_HEADS, groups, HEAD_DIM).transpose(1, 0, 2, 3, 4, 5)
    scale = jnp.float32(HEAD_DIM ** -0.5)

    def one_block(qi):
        s = jnp.einsum('bqkgd,bskd->bkgqs', qi, k, preferred_element_type=jnp.float32) * scale
        p = jax.nn.softmax(s, axis=-1)
        return jnp.einsum('bkgqs,bskd->bqkgd', p.astype(v.dtype), v)

    ob = lax.map(one_block, qb)
    return ob.transpose(1, 0, 2, 3, 4, 5).reshape(B, S, ATTN_WIDTH)


def chunked_token_mlp(z, g_v, w_s, b_s):
    B, S = z.shape[0], z.shape[1]
    nc = S // CHUNK
    z = jax.nn.gelu(z)
    u, v = jnp.split(z, 2, axis=-1)
    v = rmsnorm(v.reshape(B, S, N_TOK_HEADS, HEAD_DIM), g_v)
    v = v.reshape(B, nc, CHUNK, N_TOK_HEADS, HEAD_DIM)
    mixed = jnp.einsum('hpq,bcqhd->bcphd', w_s, v) + b_s.T[None, None, :, :, None]
    out = u.reshape(B, nc, CHUNK, N_TOK_HEADS, HEAD_DIM) * mixed
    return out.reshape(B, S, TOK_WIDTH)


def conv_glu_ffn(h, w_up, w_conv, b_conv, w_down):
    z = h @ w_up
    zp = jnp.pad(z, ((0, 0), (1, 1), (0, 0)))
    z = zp[:, :-2] * w_conv[0] + zp[:, 1:-1] * w_conv[1] + zp[:, 2:] * w_conv[2] + b_conv
    a, b = jnp.split(z, 2, axis=-1)
    return (jax.nn.silu(a) * b) @ w_down


def setup_inputs(seed: int = 0) -> dict:
    key = jax.random.key(seed)
    ks = jax.random.split(key, 24)
    f32 = jnp.float32
    L, D = DEPTH, D_MODEL

    def nrm(k, shape, scale):
        return jax.random.normal(k, shape, f32) * scale

    def gain(k, shape):
        return 1.0 + 0.05 * jax.random.normal(k, shape, f32)

    return {
        "x": nrm(ks[0], (BATCH, SEQ, D), 1.0),
        "c": nrm(ks[1], (BATCH, D), 1.0),
        "w_ada": nrm(ks[2], (L, D, N_MOD * D), 0.5 * D ** -0.5),
        "b_ada": nrm(ks[3], (L, N_MOD * D), 0.01),
        "g_norm1": gain(ks[4], (L, D)),
        "w_in": nrm(ks[5], (L, D, N_IN), D ** -0.5),
        "g_q": gain(ks[6], (L, HEAD_DIM)),
        "g_k": gain(ks[7], (L, HEAD_DIM)),
        "g_tok_v": gain(ks[8], (L, HEAD_DIM)),
        "w_s": nrm(ks[9], (L, N_TOK_HEADS, CHUNK, CHUNK), CHUNK ** -0.5),
        "b_s": 1.0 + nrm(ks[10], (L, N_TOK_HEADS, CHUNK), 0.01),
        "g_attn_out": gain(ks[11], (L, ATTN_WIDTH)),
        "g_tok_out": gain(ks[12], (L, TOK_WIDTH)),
        "w_out": nrm(ks[13], (L, MIX_WIDTH, D), MIX_WIDTH ** -0.5),
        "g_norm2": gain(ks[14], (L, D)),
        "w_up": nrm(ks[15], (L, D, 2 * D_FF), D ** -0.5),
        "w_conv": nrm(ks[16], (L, CONV_W, 2 * D_FF), CONV_W ** -0.5),
        "b_conv": nrm(ks[17], (L, 2 * D_FF), 0.01),
        "w_down": nrm(ks[18], (L, D_FF, D), D_FF ** -0.5),
        "g_final": gain(ks[19], (D,)),
    }


def reference(x, c, w_ada, b_ada, g_norm1, w_in, g_q, g_k, g_tok_v, w_s, b_s,
              g_attn_out, g_tok_out, w_out, g_norm2, w_up, w_conv, b_conv, w_down, g_final):
    B, S, _ = x.shape
    cos, sin = axial_rope_tables(S)
    cos = cos.astype(x.dtype)[None, :, None, :]
    sin = sin.astype(x.dtype)[None, :, None, :]
    mod_all = jnp.einsum('bd,ldm->lbm', jax.nn.silu(c), w_ada) + b_ada[:, None, :]

    for l in range(DEPTH):
        sh1, sc1, gt1, sh2, sc2, gt2 = jnp.split(mod_all[l][:, None, :], N_MOD, axis=-1)

        h = rmsnorm(x, g_norm1[l]) * (1.0 + sc1) + sh1
        proj = h @ w_in[l]
        q, k, v, z = jnp.split(
            proj, [ATTN_WIDTH, ATTN_WIDTH + KV_WIDTH, ATTN_WIDTH + 2 * KV_WIDTH], axis=-1)
        q = rmsnorm(q.reshape(B, S, N_Q_HEADS, HEAD_DIM), g_q[l])
        k = rmsnorm(k.reshape(B, S, N_KV_HEADS, HEAD_DIM), g_k[l])
        q = apply_axial_rope(q, cos, sin)
        k = apply_axial_rope(k, cos, sin)
        v = v.reshape(B, S, N_KV_HEADS, HEAD_DIM)
        attn = block_attention(q, k, v)
        tok = chunked_token_mlp(z, g_tok_v[l], w_s[l], b_s[l])
        mixed = jnp.concatenate(
            [rmsnorm(attn, g_attn_out[l]), rmsnorm(tok, g_tok_out[l])], axis=-1)
        x = x + gt1 * (mixed @ w_out[l])

        h = rmsnorm(x, g_norm2[l]) * (1.0 + sc2) + sh2
        x = x + gt2 * conv_glu_ffn(h, w_up[l], w_conv[l], b_conv[l], w_down[l])

    return rmsnorm(x, g_final)
```

```cpp
#include <hip/hip_runtime.h>
#include <cstdint>
#include <cstdio>

typedef unsigned short bf16_t;
typedef short bf16x8 __attribute__((ext_vector_type(8)));
typedef float f32x4 __attribute__((ext_vector_type(4)));

constexpr int D = 1024, BATCH = 2, SEQ = 8192, M = BATCH * SEQ;
constexpr int HD = 64, AW = 512, NQH = 8, NKVH = 2, KVW = 128, TW = 512, NTH = 8, NIN = 1792, CHUNK = 128, GRIDW = 64;
constexpr int DFF = 2816, NMOD = 6;
constexpr float EPS = 1e-6f;
constexpr float C2 = 0.125f * 1.4426950408889634f;

constexpr size_t MiB = 1u << 20;
constexpr size_t WS_CTL = 0;
constexpr size_t WS_MOD = 1 * MiB;
constexpr size_t WS_ROPE = WS_MOD + 64 * 1024;
constexpr size_t WS_RSTDA = WS_ROPE + 64 * 1024;
constexpr size_t WS_ROWSQ = WS_RSTDA + 64 * 1024;
constexpr size_t WS_WIN = 2 * MiB;
constexpr size_t WS_WOUT = WS_WIN + 3584 * 1024;
constexpr size_t WS_WUP = WS_WOUT + 2 * MiB;
constexpr size_t WS_WDN = WS_WUP + 11 * MiB;
constexpr size_t WS_WS = WS_ROWSQ + 512 * 1024;
constexpr size_t WS_XN = 24 * MiB;
constexpr size_t WS_Q = 56 * MiB;
constexpr size_t WS_K = WS_Q + 16 * MiB;
constexpr size_t WS_V = WS_K + 4 * MiB;
constexpr size_t WS_U = WS_V + 4 * MiB;
constexpr size_t WS_VT = WS_U + 16 * MiB;
constexpr size_t WS_MIXA = WS_VT + 16 * MiB;
constexpr size_t WS_G = 56 * MiB;
constexpr size_t WS_SCR = 144 * MiB;
static_assert(WS_WDN + 5632 * 1024 <= WS_XN && WS_MIXA + 32 * MiB == WS_SCR && WS_WS + 256 * 1024 <= WS_WIN, "ws map");

__device__ __forceinline__ unsigned f2bf(float f) { unsigned u = __builtin_bit_cast(unsigned, f); return (u + 0x7fffu + ((u >> 16) & 1u)) >> 16; }
__device__ __forceinline__ float bf2f(unsigned short h) { return __builtin_bit_cast(float, (unsigned)h << 16); }
__device__ __forceinline__ float wave_sum(float v) {
#pragma unroll
    for (int o = 1; o < 64; o <<= 1) v += __shfl_xor(v, o);
    return v;
}
__device__ __forceinline__ float silu_f(float v) { return v / (1.f + __expf(-v)); }
__device__ __forceinline__ float gelu_tanh_f(float v) { const float u = 0.7978845608028654f * (v + 0.044715f * v * v * v); return 0.5f * v * (1.f + tanhf(u)); }

__global__ void k_mod(const float* __restrict__ c, const float* __restrict__ w_ada, const float* __restrict__ b_ada, float* __restrict__ mod) {
    const int j = blockIdx.x * blockDim.x + threadIdx.x, b = blockIdx.y;
    float acc = 0.f;
    for (int k = 0; k < D; ++k) acc += silu_f(c[b * D + k]) * w_ada[(size_t)k * (NMOD * D) + j];
    mod[b * (NMOD * D) + j] = acc + b_ada[j];
}
__global__ void k_rope(float* __restrict__ tab) {
    const int p = blockIdx.x, i = threadIdx.x;
    const float inv = powf(10000.f, -(float)(2 * i) / 32.f);
    const float a = (float)p * inv;
    tab[p * 16 + i] = cosf(a); tab[2048 + p * 16 + i] = sinf(a);
}
__global__ void k_wt(const float* __restrict__ W, int K, int N, bf16_t* __restrict__ Wt, const float* __restrict__ ks0, const float* __restrict__ ks1, int ksplit) {
    __shared__ float tile[32][33];
    const int k0 = blockIdx.y * 32, n0 = blockIdx.x * 32, tx = threadIdx.x & 31, ty = threadIdx.x >> 5;
    for (int i = ty; i < 32; i += 8) { const int k = k0 + i; float s = 1.f; if (ks0) s = (k < ksplit) ? ks0[k] : ks1[k - ksplit]; tile[i][tx] = W[(size_t)k * N + n0 + tx] * s; }
    __syncthreads();
    for (int i = ty; i < 32; i += 8) Wt[(size_t)(n0 + i) * K + k0 + tx] = (bf16_t)f2bf(tile[tx][i]);
}
__global__ void k_cvt(const float* __restrict__ s, bf16_t* __restrict__ d, int n) { const int i = blockIdx.x * blockDim.x + threadIdx.x; if (i < n) d[i] = (bf16_t)f2bf(s[i]); }

__global__ __launch_bounds__(256) void k_norm_mod(const float* __restrict__ xin, const float* __restrict__ Cacc, const float* __restrict__ rowscale, const float* __restrict__ gate, float* __restrict__ xout,
                                                 const float* __restrict__ g, const float* __restrict__ sc, const float* __restrict__ sh, bf16_t* __restrict__ xn, float* __restrict__ fin, const float* __restrict__ gfin) {
    __shared__ float red[4];
    const int row = blockIdx.x, b = row / SEQ, t = threadIdx.x;
    f32x4 v = *(const f32x4*)(xin + (size_t)row * D + 4 * t);
    if (Cacc) { const f32x4 cc = *(const f32x4*)(Cacc + (size_t)row * D + 4 * t); const f32x4 gt = *(const f32x4*)(gate + b * (NMOD * D) + 4 * t); const float rs = rowscale ? rowscale[row] : 1.f; v = v + gt * (cc * rs); }
    if (xout) *(f32x4*)(xout + (size_t)row * D + 4 * t) = v;
    float ss = v.x * v.x + v.y * v.y + v.z * v.z + v.w * v.w; ss = wave_sum(ss);
    if ((t & 63) == 0) red[t >> 6] = ss;
    __syncthreads();
    const float rstd = rsqrtf((red[0] + red[1] + red[2] + red[3]) * (1.f / D) + EPS);
    if (fin) { const f32x4 gg = *(const f32x4*)(gfin + 4 * t); *(f32x4*)(fin + (size_t)row * D + 4 * t) = v * rstd * gg; return; }
    const f32x4 gg = *(const f32x4*)(g + 4 * t), s1 = *(const f32x4*)(sc + b * (NMOD * D) + 4 * t), s0 = *(const f32x4*)(sh + b * (NMOD * D) + 4 * t);
    const f32x4 o = v * rstd * gg * (1.f + s1) + s0;
    unsigned long long pk = (unsigned long long)(f2bf(o.x) | (f2bf(o.y) << 16)) | ((unsigned long long)(f2bf(o.z) | (f2bf(o.w) << 16)) << 32);
    *(unsigned long long*)(xn + (size_t)row * D + 4 * t) = pk;
}

__global__ __launch_bounds__(256) void k_gemm(const bf16_t* __restrict__ A, const bf16_t* __restrict__ Bt, float* __restrict__ C, int K, int ldc) {
    const int wave = threadIdx.x >> 6, lane = threadIdx.x & 63;
    const int row0 = blockIdx.y * 128 + wave * 32, col0 = blockIdx.x * 64;
    f32x4 acc[2][4];
#pragma unroll
    for (int i = 0; i < 2; ++i)
#pragma unroll
        for (int j = 0; j < 4; ++j) acc[i][j] = (f32x4){0.f, 0.f, 0.f, 0.f};
    const bf16_t* ap = A + (size_t)(row0 + (lane & 15)) * K + 8 * (lane >> 4);
    const bf16_t* bp = Bt + (size_t)(col0 + (lane & 15)) * K + 8 * (lane >> 4);
    for (int k = 0; k < K; k += 32) {
        bf16x8 a[2], b[4];
#pragma unroll
        for (int i = 0; i < 2; ++i) a[i] = *(const bf16x8*)(ap + (size_t)i * 16 * K + k);
#pragma unroll
        for (int j = 0; j < 4; ++j) b[j] = *(const bf16x8*)(bp + (size_t)j * 16 * K + k);
#pragma unroll
        for (int i = 0; i < 2; ++i)
#pragma unroll
            for (int j = 0; j < 4; ++j) acc[i][j] = __builtin_amdgcn_mfma_f32_16x16x32_bf16(a[i], b[j], acc[i][j], 0, 0, 0);
    }
#pragma unroll
    for (int i = 0; i < 2; ++i)
#pragma unroll
        for (int j = 0; j < 4; ++j)
#pragma unroll
            for (int r = 0; r < 4; ++r) C[(size_t)(row0 + i * 16 + 4 * (lane >> 4) + r) * ldc + col0 + j * 16 + (lane & 15)] = acc[i][j][r];
}

__global__ __launch_bounds__(256) void k_post_in(const float* __restrict__ proj, const float* __restrict__ g_q, const float* __restrict__ g_k, const float* __restrict__ g_tv, const float* __restrict__ rope,
                                                bf16_t* __restrict__ Q, bf16_t* __restrict__ Kb, bf16_t* __restrict__ Vb, bf16_t* __restrict__ U, bf16_t* __restrict__ VT) {
    const int row = blockIdx.x, t = row % SEQ, wave = threadIdx.x >> 6, d = threadIdx.x & 63;
    const float* pr = proj + (size_t)row * NIN;
    for (int grp = wave; grp < NIN / 64; grp += 4) {
        const float x = pr[grp * 64 + d];
        if (grp < 10) {
            const float rstd = rsqrtf(wave_sum(x * x) * (1.f / 64.f) + EPS);
            const float gg = grp < 8 ? g_q[d] : g_k[d];
            const float y = x * rstd * gg;
            const int sec = d >> 5, dd = d & 31, i = dd & 15;
            const int pos = sec == 0 ? (t / GRIDW) : (t % GRIDW);
            const float cs = rope[pos * 16 + i], sn = rope[2048 + pos * 16 + i];
            const float partner = __shfl(y, (d & 32) | ((dd + 16) & 31));
            const float rot = dd < 16 ? -partner : partner;
            const float o = y * cs + rot * sn;
            if (grp < 8) Q[(size_t)row * AW + grp * 64 + d] = (bf16_t)f2bf(o * C2);
            else Kb[(size_t)row * KVW + (grp - 8) * 64 + d] = (bf16_t)f2bf(o);
        } else if (grp < 12) {
            Vb[(size_t)row * KVW + (grp - 10) * 64 + d] = (bf16_t)f2bf(x);
        } else if (grp < 20) {
            U[(size_t)row * TW + (grp - 12) * 64 + d] = (bf16_t)f2bf(gelu_tanh_f(x));
        } else {
            const float z = gelu_tanh_f(x);
            const float rstd = rsqrtf(wave_sum(z * z) * (1.f / 64.f) + EPS);
            VT[(size_t)row * TW + (grp - 20) * 64 + d] = (bf16_t)f2bf(z * rstd * g_tv[d]);
        }
    }
}

__global__ __launch_bounds__(64) void k_attn(const bf16_t* __restrict__ Q, const bf16_t* __restrict__ Kb, const bf16_t* __restrict__ Vb, bf16_t* __restrict__ MIXA, float* __restrict__ rowsq) {
    const int t = blockIdx.x * 64 + threadIdx.x, h = blockIdx.y, b = blockIdx.z, kvh = h >> 2;
    const size_t row = (size_t)b * SEQ + t;
    float q[64], o[64];
#pragma unroll
    for (int d = 0; d < 64; ++d) { q[d] = bf2f(Q[row * AW + h * 64 + d]); o[d] = 0.f; }
    float m = -1e30f, l = 0.f;
    const bf16_t* kp = Kb + (size_t)b * SEQ * KVW + kvh * 64;
    const bf16_t* vp = Vb + (size_t)b * SEQ * KVW + kvh * 64;
    for (int s0 = 0; s0 < SEQ; s0 += 8) {
        float sc[8]; float cm = -1e30f;
#pragma unroll
        for (int j = 0; j < 8; ++j) {
            const bf16_t* kr = kp + (size_t)(s0 + j) * KVW; float a = 0.f;
#pragma unroll
            for (int d = 0; d < 64; ++d) a += q[d] * bf2f(kr[d]);
            sc[j] = a; cm = fmaxf(cm, a);
        }
        const float mn = fmaxf(m, cm), alpha = exp2f(m - mn); m = mn; l *= alpha;
#pragma unroll
        for (int d = 0; d < 64; ++d) o[d] *= alpha;
#pragma unroll
        for (int j = 0; j < 8; ++j) {
            const float p = exp2f(sc[j] - mn); l += p; const float pb = bf2f((unsigned short)f2bf(p));
            const bf16_t* vr = vp + (size_t)(s0 + j) * KVW;
#pragma unroll
            for (int d = 0; d < 64; ++d) o[d] += pb * bf2f(vr[d]);
        }
    }
    const float rl = 1.f / l; float ss = 0.f;
#pragma unroll
    for (int d = 0; d < 64; ++d) { const unsigned short ob = (unsigned short)f2bf(o[d] * rl); MIXA[row * D + h * 64 + d] = ob; const float of = bf2f(ob); ss += of * of; }
    rowsq[(size_t)h * M + row] = ss;
}

__global__ __launch_bounds__(512) void k_tok(const bf16_t* __restrict__ U, const bf16_t* __restrict__ VT, const bf16_t* __restrict__ Wsb, const float* __restrict__ b_s, const float* __restrict__ rowsq,
                                            bf16_t* __restrict__ MIXA, float* __restrict__ rstd_a) {
    __shared__ float red[8];
    const int row = blockIdx.x, c = threadIdx.x, h = c >> 6, p = row % CHUNK; const size_t base = (size_t)(row - p);
    float acc = 0.f;
    for (int qq = 0; qq < CHUNK; ++qq) acc += bf2f(Wsb[(h * CHUNK + p) * CHUNK + qq]) * bf2f(VT[(base + qq) * TW + c]);
    const float tok = bf2f(U[(size_t)row * TW + c]) * (acc + b_s[h * CHUNK + p]);
    float ss = wave_sum(tok * tok); if ((c & 63) == 0) red[c >> 6] = ss;
    __syncthreads();
    float tot = 0.f, sa = 0.f;
#pragma unroll
    for (int i = 0; i < 8; ++i) { tot += red[i]; sa += rowsq[(size_t)i * M + row]; }
    const float rt = rsqrtf(tot * (1.f / TW) + EPS), ra = rsqrtf(sa * (1.f / AW) + EPS);
    MIXA[(size_t)row * D + AW + c] = (bf16_t)f2bf(tok * rt / ra);
    if (c == 0) rstd_a[row] = ra;
}

__global__ __launch_bounds__(256) void k_conv_gate(const float* __restrict__ z, int CW, int c0, const float* __restrict__ w_conv, const float* __restrict__ b_conv, bf16_t* __restrict__ G) {
    const int row = blockIdx.y, t = row % SEQ, c = blockIdx.x * 256 + threadIdx.x; if (c >= CW) return;
    const int ca = c0 + c, cb = DFF + c0 + c; const int ld = 2 * CW;
    const float* zr = z + (size_t)row * ld;
    float a = zr[c] * w_conv[2 * DFF + ca] + b_conv[ca], bb = zr[CW + c] * w_conv[2 * DFF + cb] + b_conv[cb];
    if (t > 0) { a += zr[c - ld] * w_conv[ca]; bb += zr[CW + c - ld] * w_conv[cb]; }
    if (t < SEQ - 1) { a += zr[c + ld] * w_conv[2 * (2 * DFF) + ca]; bb += zr[CW + c + ld] * w_conv[2 * (2 * DFF) + cb]; }
    G[(size_t)row * DFF + ca] = (bf16_t)f2bf(silu_f(a) * bb);
}

extern "C" void kernel_launch(void* const* d_in, const int* in_sizes, int n_in, void* d_out, int out_size, void* d_ws, size_t ws_size, hipStream_t stream) {
    const float* x = (const float*)d_in[0]; const float* c = (const float*)d_in[1]; const float* w_ada = (const float*)d_in[2]; const float* b_ada = (const float*)d_in[3];
    const float* g_norm1 = (const float*)d_in[4]; const float* w_in = (const float*)d_in[5]; const float* g_q = (const float*)d_in[6]; const float* g_k = (const float*)d_in[7];
    const float* g_tok_v = (const float*)d_in[8]; const float* w_s = (const float*)d_in[9]; const float* b_s = (const float*)d_in[10]; const float* g_attn_out = (const float*)d_in[11];
    const float* g_tok_out = (const float*)d_in[12]; const float* w_out = (const float*)d_in[13]; const float* g_norm2 = (const float*)d_in[14]; const float* w_up = (const float*)d_in[15];
    const float* w_conv = (const float*)d_in[16]; const float* b_conv = (const float*)d_in[17]; const float* w_down = (const float*)d_in[18]; const float* g_final = (const float*)d_in[19];
    float* out = (float*)d_out; unsigned char* ws = (unsigned char*)d_ws;
    float* mod = (float*)(ws + WS_MOD); float* rope = (float*)(ws + WS_ROPE); float* rstd_a = (float*)(ws + WS_RSTDA); float* rowsq = (float*)(ws + WS_ROWSQ);
    bf16_t* WIN = (bf16_t*)(ws + WS_WIN); bf16_t* WOUT = (bf16_t*)(ws + WS_WOUT); bf16_t* WUP = (bf16_t*)(ws + WS_WUP); bf16_t* WDN = (bf16_t*)(ws + WS_WDN); bf16_t* WSB = (bf16_t*)(ws + WS_WS);
    bf16_t* XN = (bf16_t*)(ws + WS_XN); bf16_t* Q = (bf16_t*)(ws + WS_Q); bf16_t* Kb = (bf16_t*)(ws + WS_K); bf16_t* Vb = (bf16_t*)(ws + WS_V); bf16_t* U = (bf16_t*)(ws + WS_U); bf16_t* VT = (bf16_t*)(ws + WS_VT);
    bf16_t* MIXA = (bf16_t*)(ws + WS_MIXA); bf16_t* G = (bf16_t*)(ws + WS_G); float* scr = (float*)(ws + WS_SCR);
    if (ws_size < 256 * MiB) { fprintf(stderr, "ws too small\n"); return; }

    k_mod<<<dim3(NMOD * D / 256, BATCH), 256, 0, stream>>>(c, w_ada, b_ada, mod);
    k_rope<<<128, 16, 0, stream>>>(rope);
    k_wt<<<dim3(NIN / 32, D / 32), 256, 0, stream>>>(w_in, D, NIN, WIN, nullptr, nullptr, 0);
    k_wt<<<dim3(D / 32, D / 32), 256, 0, stream>>>(w_out, D, D, WOUT, g_attn_out, g_tok_out, AW);
    k_wt<<<dim3(2 * DFF / 32, D / 32), 256, 0, stream>>>(w_up, D, 2 * DFF, WUP, nullptr, nullptr, 0);
    k_wt<<<dim3(D / 32, DFF / 32), 256, 0, stream>>>(w_down, DFF, D, WDN, nullptr, nullptr, 0);
    k_cvt<<<NTH * CHUNK * CHUNK / 256, 256, 0, stream>>>(w_s, WSB, NTH * CHUNK * CHUNK);
    k_norm_mod<<<M, 256, 0, stream>>>(x, nullptr, nullptr, nullptr, nullptr, g_norm1, mod + 1 * D, mod + 0 * D, XN, nullptr, nullptr);
    k_gemm<<<dim3(NIN / 64, M / 128), 256, 0, stream>>>(XN, WIN, scr, D, NIN);
    k_post_in<<<M, 256, 0, stream>>>(scr, g_q, g_k, g_tok_v, rope, Q, Kb, Vb, U, VT);
    k_attn<<<dim3(SEQ / 64, NQH, BATCH), 64, 0, stream>>>(Q, Kb, Vb, MIXA, rowsq);
    k_tok<<<M, 512, 0, stream>>>(U, VT, WSB, b_s, rowsq, MIXA, rstd_a);
    k_gemm<<<dim3(D / 64, M / 128), 256, 0, stream>>>(MIXA, WOUT, scr, D, D);
    k_norm_mod<<<M, 256, 0, stream>>>(x, scr, rstd_a, mod + 2 * D, out, g_norm2, mod + 4 * D, mod + 3 * D, XN, nullptr, nullptr);
    constexpr int CW = 704;
    for (int ch = 0; ch < 4; ++ch) {
        k_gemm<<<dim3(CW / 64, M / 128), 256, 0, stream>>>(XN, WUP + (size_t)(ch * CW) * D, scr, D, 2 * CW);
        k_gemm<<<dim3(CW / 64, M / 128), 256, 0, stream>>>(XN, WUP + (size_t)(DFF + ch * CW) * D, scr + CW, D, 2 * CW);
        k_conv_gate<<<dim3((CW + 255) / 256, M), 256, 0, stream>>>(scr, CW, ch * CW, w_conv, b_conv, G);
    }
    k_gemm<<<dim3(D / 64, M / 128), 256, 0, stream>>>(G, WDN, scr, DFF, D);
    k_norm_mod<<<M, 256, 0, stream>>>(out, scr, nullptr, mod + 5 * D, nullptr, nullptr, nullptr, nullptr, nullptr, out, g_final);
}
```
